# Optimizing an MI355X kernel written in HIP

```python
import jax, jax.numpy as jnp
from jax import lax
import numpy as np

D_MODEL = 1024
BATCH = 8
SEQ = 4096
DEPTH = 1

CHUNK = 64
N_HEADS_SB = 8
HEAD_DIM_SB = 64
D_SB = N_HEADS_SB * HEAD_DIM_SB
N_GROUPS_SGU = 8
GROUP_DIM_SGU = 64
D_SGU = N_GROUPS_SGU * GROUP_DIM_SGU
SGU_CHUNK = 128
Q_BLOCK = 128
EPS = 1e-6
IN_WIDTHS = (D_SB, D_SB, D_SB, D_SB, D_SGU, D_SGU, D_SGU, D_MODEL, D_MODEL)
D_IN = 4 * D_SB + 3 * D_SGU + 2 * D_MODEL

kernel_name = 'stickbreak_sgu_gated_hybrid'


def rmsnorm(x, g):
    xf = x.astype(jnp.float32)
    y = xf * lax.rsqrt(jnp.mean(xf * xf, axis=-1, keepdims=True) + EPS)
    return (y * g.astype(jnp.float32)).astype(x.dtype)


def split_points():
    pts, acc = [], 0
    for w in IN_WIDTHS[:-1]:
        acc += w
        pts.append(acc)
    return pts


def stick_breaking_attention(q, k, v):
    b, s, h, dh = q.shape
    scale = dh ** -0.5
    qf = q.astype(jnp.float32).transpose(0, 2, 1, 3) * scale
    kf = k.astype(jnp.float32).transpose(0, 2, 1, 3)
    vf = v.astype(jnp.float32).transpose(0, 2, 1, 3)
    outs = []
    for start in range(0, s, Q_BLOCK):
        end = start + Q_BLOCK
        qb = qf[:, :, start:end]
        kb = kf[:, :, :end]
        vb = vf[:, :, :end]
        z = jnp.einsum('bhqd,bhkd->bhqk', qb, kb)
        t_idx = start + jnp.arange(Q_BLOCK)[:, None]
        s_idx = jnp.arange(end)[None, :]
        before = s_idx < t_idx
        log_keep = jnp.where(before, jax.nn.log_sigmoid(-z), 0.0)
        log_stick = lax.cumsum(log_keep, axis=3, reverse=True) - log_keep
        log_w = jax.nn.log_sigmoid(z) + log_stick
        w = jnp.where(before, jnp.exp(log_w), 0.0)
        outs.append(jnp.einsum('bhqk,bhkd->bhqd', w, vb))
    o = jnp.concatenate(outs, axis=2)
    return o.transpose(0, 2, 1, 3).astype(q.dtype)


def spatial_gating(u, v, ln_g, ln_b, w_s, b_s):
    b, s, g, c = v.shape
    vf = v.astype(jnp.float32)
    mu = jnp.mean(vf, axis=-1, keepdims=True)
    var = jnp.mean(jnp.square(vf - mu), axis=-1, keepdims=True)
    vn = (vf - mu) * lax.rsqrt(var + EPS) * ln_g.astype(jnp.float32) + ln_b.astype(jnp.float32)
    vn = vn.reshape(b, s // SGU_CHUNK, SGU_CHUNK, g, c)
    pos = jnp.arange(SGU_CHUNK)
    mask = (pos[None, :] // CHUNK) <= (pos[:, None] // CHUNK)
    w = jnp.where(mask[None], w_s.astype(jnp.float32), 0.0)
    mixed = jnp.einsum('gts,bnsgc->bntgc', w, vn) + b_s.astype(jnp.float32).T[None, None, :, :, None]
    return u * mixed.reshape(b, s, g, c).astype(u.dtype)


def setup_inputs(seed: int = 0) -> dict:
    key = jax.random.key(seed)
    ks = jax.random.split(key, 13)
    f32 = jnp.float32
    x = jax.random.normal(ks[0], (BATCH, SEQ, D_MODEL), f32)
    norm_g = 1.0 + 0.1 * jax.random.normal(ks[1], (DEPTH, D_MODEL), f32)
    w_in = jax.random.normal(ks[2], (DEPTH, D_MODEL, D_IN), f32) * D_MODEL ** -0.5
    sgu_ln_g = 1.0 + 0.1 * jax.random.normal(ks[3], (DEPTH, N_GROUPS_SGU, GROUP_DIM_SGU), f32)
    sgu_ln_b = 0.1 * jax.random.normal(ks[4], (DEPTH, N_GROUPS_SGU, GROUP_DIM_SGU), f32)
    w_spatial = jax.random.normal(ks[5], (DEPTH, N_GROUPS_SGU, SGU_CHUNK, SGU_CHUNK), f32) * SGU_CHUNK ** -0.5
    b_spatial = 1.0 + 0.1 * jax.random.normal(ks[6], (DEPTH, N_GROUPS_SGU, SGU_CHUNK), f32)
    w_up_a = jax.random.normal(ks[7], (DEPTH, D_SB, D_MODEL), f32) * D_SB ** -0.5
    w_up_b = jax.random.normal(ks[8], (DEPTH, D_SGU, D_MODEL), f32) * D_SGU ** -0.5
    w_out = jax.random.normal(ks[9], (DEPTH, D_MODEL, D_MODEL), f32) * D_MODEL ** -0.5
    final_norm_g = 1.0 + 0.1 * jax.random.normal(ks[10], (D_MODEL,), f32)
    return {'x': x, 'norm_g': norm_g, 'w_in': w_in, 'sgu_ln_g': sgu_ln_g, 'sgu_ln_b': sgu_ln_b,
            'w_spatial': w_spatial, 'b_spatial': b_spatial, 'w_up_a': w_up_a, 'w_up_b': w_up_b,
            'w_out': w_out, 'final_norm_g': final_norm_g}


def reference(x, norm_g, w_in, sgu_ln_g, sgu_ln_b, w_spatial, b_spatial, w_up_a, w_up_b, w_out, final_norm_g):
    b, s, _ = x.shape
    pts = split_points()
    for l in range(DEPTH):
        h = rmsnorm(x, norm_g[l])
        proj = jnp.einsum('bsd,de->bse', h, w_in[l])
        q, k, v, z_a, u_b, v_b, z_b, g_a, g_b = jnp.split(proj, pts, axis=-1)
        y_a = stick_breaking_attention(
            q.reshape(b, s, N_HEADS_SB, HEAD_DIM_SB),
            k.reshape(b, s, N_HEADS_SB, HEAD_DIM_SB),
            v.reshape(b, s, N_HEADS_SB, HEAD_DIM_SB)).reshape(b, s, D_SB) * jax.nn.silu(z_a)
        y_b = spatial_gating(
            jax.nn.gelu(u_b).reshape(b, s, N_GROUPS_SGU, GROUP_DIM_SGU),
            jax.nn.gelu(v_b).reshape(b, s, N_GROUPS_SGU, GROUP_DIM_SGU),
            sgu_ln_g[l], sgu_ln_b[l], w_spatial[l], b_spatial[l]).reshape(b, s, D_SGU) * jax.nn.silu(z_b)
        p_a = jnp.einsum('bse,ed->bsd', y_a, w_up_a[l])
        p_b = jnp.einsum('bse,ed->bsd', y_b, w_up_b[l])
        merged = jax.nn.sigmoid(g_a) * p_a + jax.nn.sigmoid(g_b) * p_b
        x = x + jnp.einsum('bsd,de->bse', merged, w_out[l])
    return rmsnorm(x, final_norm_g)
```

```cpp
#include <hip/hip_cooperative_groups.h>
#include <hip/hip_runtime.h>
#include <cstdio>
#include <cstdint>
namespace pg8 {
#define PG8_LAS __attribute__((address_space(3)))
typedef unsigned short bf16_t;
typedef short bf16x8 __attribute__((ext_vector_type(8)));
typedef float f32x4 __attribute__((ext_vector_type(4)));
typedef unsigned u32x4 __attribute__((ext_vector_type(4)));
constexpr int BM = 256, BK = 64, HALF = 128, HTB = HALF * BK * 2  , STAGE_BYTES = 8 * HTB, NXCD = 8, WGM = 8;

__host__ __device__ __forceinline__ int lds_byte(int r, int c) { const int st = (r >> 4) * 2 + (c >> 5), rr = r & 15, cc = c & 31, ob = rr * 64 + cc * 2; return st * 1024 + (ob ^ (((ob >> 9) & 1) << 5)); }
__host__ __device__ __forceinline__ void stage_rc(int b, int& R, int& C) { const int st = b / 1024, sb = b % 1024, swz = sb ^ (((sb >> 9) & 1) << 5); R = (st >> 1) * 16 + swz / 64; C = (st & 1) * 32 + (swz % 64) / 2; }
__host__ __device__ __forceinline__ int perm32(int rho) { const int n = rho >> 4, i = rho & 15; return 8 * (i >> 2) + 4 * n + (i & 3); }

struct Unit { int pm, pn; };
struct Gemm { const bf16_t* A; const bf16_t* Bt; int M, N, K; };

struct StaticOrder {
    int nM, nN, nwg, G, c;
    __host__ __device__ void init(int M, int N, int G_, int c_) { nM = M / BM; nN = N / BM; nwg = nM * nN; G = G_; c = c_; }
    __host__ __device__ bool next(int i, Unit& u) const {
        const long L = (long)i * G + c; if (L >= nwg) return false;
        int wgid = (int)L; { const int q = nwg / NXCD, r = nwg % NXCD, xcd = wgid % NXCD, off = wgid / NXCD; wgid = (xcd < r ? xcd * (q + 1) : r * (q + 1) + (xcd - r) * q) + off; }
        const int nig = WGM * nN, gid = wgid / nig, fm = gid * WGM, gsz = (nM - fm) < WGM ? (nM - fm) : WGM;
        u.pm = fm + ((wgid % nig) % gsz); u.pn = (wgid % nig) / gsz; return true;
    }
    __device__ __forceinline__ void a_ready(const Unit&) const {}
    __device__ __forceinline__ void done(const Unit&) const {}
};

__device__ __forceinline__ unsigned cvt_pk_bf16(float lo, float hi) { unsigned r; asm volatile("v_cvt_pk_bf16_f32 %0, %1, %2" : "=v"(r) : "v"(lo), "v"(hi)); return r; }
typedef float f32x2 __attribute__((ext_vector_type(2)));
typedef unsigned u32x2 __attribute__((ext_vector_type(2)));
typedef __bf16 bf16x2v __attribute__((ext_vector_type(2)));
__device__ __forceinline__ unsigned cvt2(float lo, float hi) { f32x2 v = {lo, hi}; bf16x2v b = __builtin_convertvector(v, bf16x2v); return __builtin_bit_cast(unsigned, b); }
__device__ __forceinline__ float sigmoid_f(float v) { return __builtin_amdgcn_rcpf(1.0f + __builtin_amdgcn_exp2f(-1.4426950408889634f * v)); }
__device__ __forceinline__ float silu_f(float v) { return v * sigmoid_f(v); }
__device__ __forceinline__ float gelu_tanh_f(float v) { return v * sigmoid_f(1.5957691216057308f * (v + 0.044715f * v * v * v)); }
__device__ __forceinline__ float bf_lo(unsigned w) { return __builtin_bit_cast(float, w << 16); }
__device__ __forceinline__ float bf_hi(unsigned w) { return __builtin_bit_cast(float, w & 0xffff0000u); }
constexpr float QK_C2 = 0.125f * 1.4426950408889634f;

struct EpiInProj {
    static constexpr bool PERM = true, AFTER_DRAIN = false;
    unsigned char* segbase; size_t seg_stride512, seg_off1024, seg_stride1024;
    template <int ACT> __device__ __forceinline__ void body(const f32x4 (&acc)[2][2][4][2], bf16_t* base, int ldc, int row0, int col0) const {
#pragma unroll
        for (int ai = 0; ai < 2; ++ai)
#pragma unroll
            for (int m = 0; m < 4; ++m) { bf16_t* rowp = base + (size_t)(row0 + ai * HALF + m * 16) * ldc + col0;
#pragma unroll
                for (int bj = 0; bj < 2; ++bj) { float f[8];
#pragma unroll
                    for (int i = 0; i < 4; ++i) { f[i] = acc[ai][bj][m][0][i]; f[4 + i] = acc[ai][bj][m][1][i]; }
#pragma unroll
                    for (int i = 0; i < 8; ++i) { if (ACT == 0) f[i] *= QK_C2; else if (ACT == 2) f[i] = silu_f(f[i]); else if (ACT == 3) f[i] = gelu_tanh_f(f[i]); else if (ACT == 4) f[i] = sigmoid_f(f[i]); }
                    u32x4 w; w.x = cvt2(f[0], f[1]); w.y = cvt2(f[2], f[3]); w.z = cvt2(f[4], f[5]); w.w = cvt2(f[6], f[7]);
                    *(u32x4*)(rowp + bj * HALF) = w; } }
    }
    __device__ __forceinline__ void operator()(const f32x4 (&acc)[2][2][4][2], const Unit& u, int wr, int wc, int fr, int fq) const {
        const int row0 = u.pm * BM + wr * 64 + fr; const int colt = u.pn * BM;
        int s, lc, ldc;
        if (colt < 3584) { s = colt >> 9; lc = colt & 511; ldc = 512; } else { s = 7 + ((colt - 3584) >> 10); lc = (colt - 3584) & 1023; ldc = 1024; }
        const int col0 = lc + wc * 32 + 8 * fq; bf16_t* base = (bf16_t*)(s < 7 ? segbase + (size_t)s * seg_stride512 : segbase + seg_off1024 + (size_t)(s - 7) * seg_stride1024);
        if (s == 0) body<0>(acc, base, ldc, row0, col0);
        else if (s <= 2) body<1>(acc, base, ldc, row0, col0);
        else if (s == 3 || s == 6) body<2>(acc, base, ldc, row0, col0);
        else if (s == 4 || s == 5) body<3>(acc, base, ldc, row0, col0);
        else body<4>(acc, base, ldc, row0, col0);
    }
};
template <int PASS> struct EpiGate {
    static constexpr bool PERM = true, AFTER_DRAIN = false;
    const bf16_t* G; bf16_t* MG;
    __device__ __forceinline__ void operator()(const f32x4 (&acc)[2][2][4][2], const Unit& u, int wr, int wc, int fr, int fq) const {
        const int row0 = u.pm * BM + wr * 64 + fr, col0 = u.pn * BM + wc * 32 + 8 * fq;
#pragma unroll
        for (int ai = 0; ai < 2; ++ai)
#pragma unroll
            for (int m = 0; m < 4; ++m) {
#pragma unroll
                for (int bj = 0; bj < 2; ++bj) { const size_t off = (size_t)(row0 + ai * HALF + m * 16) * 1024 + col0 + bj * HALF;
                    const u32x4 gv = *(const u32x4*)(G + off); float f[8];
#pragma unroll
                    for (int i = 0; i < 4; ++i) { f[i] = acc[ai][bj][m][0][i]; f[4 + i] = acc[ai][bj][m][1][i]; }
                    f[0] *= bf_lo(gv.x); f[1] *= bf_hi(gv.x); f[2] *= bf_lo(gv.y); f[3] *= bf_hi(gv.y); f[4] *= bf_lo(gv.z); f[5] *= bf_hi(gv.z); f[6] *= bf_lo(gv.w); f[7] *= bf_hi(gv.w);
                    if (PASS == 1) { const u32x4 pv = *(const u32x4*)(MG + off);
                        f[0] += bf_lo(pv.x); f[1] += bf_hi(pv.x); f[2] += bf_lo(pv.y); f[3] += bf_hi(pv.y); f[4] += bf_lo(pv.z); f[5] += bf_hi(pv.z); f[6] += bf_lo(pv.w); f[7] += bf_hi(pv.w); }
                    u32x4 w; w.x = cvt2(f[0], f[1]); w.y = cvt2(f[2], f[3]); w.z = cvt2(f[4], f[5]); w.w = cvt2(f[6], f[7]);
                    *(u32x4*)(MG + off) = w; } }
    }
};
struct EpiResid {
    static constexpr bool PERM = false, AFTER_DRAIN = false;
    const float* x; float* out;
    __device__ __forceinline__ void operator()(const f32x4 (&acc)[2][2][4][2], const Unit& u, int wr, int wc, int fr, int fq) const {
        const int col0 = u.pn * BM + wc * 32 + 4 * fq;
#pragma unroll
        for (int ai = 0; ai < 2; ++ai)
#pragma unroll
            for (int m = 0; m < 4; ++m) { const int r = u.pm * BM + ai * HALF + wr * 64 + m * 16 + fr; const size_t off = (size_t)r * 1024 + col0;
#pragma unroll
                for (int bj = 0; bj < 2; ++bj)
#pragma unroll
                    for (int n = 0; n < 2; ++n) { const f32x4 xv = *(const f32x4*)(x + off + bj * HALF + n * 16); const f32x4 y = xv + acc[ai][bj][m][n];
                        *(f32x4*)(out + off + bj * HALF + n * 16) = y; } }
    }
};
template <class Epi, class Sched, bool ALIGN_EPI = false, bool SP2 = false>
__device__ __forceinline__ void gemm_phase(PG8_LAS unsigned char* lds, const Gemm g, const Sched& S, const Epi& E) {
    const int tid = threadIdx.x, wid = __builtin_amdgcn_readfirstlane(tid >> 6), lane = tid & 63, wr = wid >> 2, wc = wid & 3, fr = lane & 15, fq = lane >> 4;
    const int K = g.K, nt = K / BK;
    unsigned voffA[2], voffB[2];
#pragma unroll
    for (int i = 0; i < 2; ++i) { int R, C; stage_rc(tid * 16 + i * 8192, R, C); const int Rb = Epi::PERM ? ((R & ~31) + perm32(R & 31)) : R;
        voffA[i] = (unsigned)(R * K + C) * 2u; voffB[i] = (unsigned)(Rb * K + C) * 2u; }
    const size_t kstep = (size_t)(BK * 2);
    const size_t hstep = (size_t)HALF * K * 2;
    const size_t tstep = 2 * hstep;
    const unsigned ldsw = (unsigned)wid * 1024u;
    const int aoff = lds_byte(wr * 64 + fr, fq * 8), boff = lds_byte(wc * 32 + fr, fq * 8);
#define PG8_SA(b, h) (((b) * 2 + (h)) * HTB)
#define PG8_SB(b, h) ((4 + (b) * 2 + (h)) * HTB)
#define PG8_STAGE(bufoff, gbase, voff) do { _Pragma("unroll") for (int _i = 0; _i < 2; ++_i) \
        __builtin_amdgcn_global_load_lds((const unsigned*)((const char*)(gbase) + (voff)[_i]), (PG8_LAS unsigned*)(lds + (bufoff) + ldsw + _i * 8192), 16, 0, 0); } while (0)
#define PG8_LDA(dst, b, h) do { _Pragma("unroll") for (int m = 0; m < 4; ++m) _Pragma("unroll") for (int k = 0; k < 2; ++k) dst[m][k] = *(const PG8_LAS bf16x8*)(lds + PG8_SA(b, h) + aoff + m * 2048 + k * 1024); } while (0)
#define PG8_LDB(dst, b, h) do { _Pragma("unroll") for (int n = 0; n < 2; ++n) _Pragma("unroll") for (int k = 0; k < 2; ++k) dst[n][k] = *(const PG8_LAS bf16x8*)(lds + PG8_SB(b, h) + boff + n * 2048 + k * 1024); } while (0)
#define PG8_MMA(ai, bj, At, Bt) do { __builtin_amdgcn_s_setprio(1); _Pragma("unroll") for (int m = 0; m < 4; ++m) _Pragma("unroll") for (int n = 0; n < 2; ++n) _Pragma("unroll") for (int k = 0; k < 2; ++k) \
        acc[ai][bj][m][n] = __builtin_amdgcn_mfma_f32_16x16x32_bf16(Bt[n][k], At[m][k], acc[ai][bj][m][n], 0, 0, 0); __builtin_amdgcn_s_setprio(0); } while (0)
#define PG8_WAIT_V(n) asm volatile("s_waitcnt vmcnt(" #n ")" ::: "memory")
#define PG8_WAIT_L(n) asm volatile("s_waitcnt lgkmcnt(" #n ")" ::: "memory")
#define PG8_BAR __builtin_amdgcn_s_barrier()
#define PG8_SCHED __builtin_amdgcn_sched_barrier(0)
    Unit cur, nxt; int ui = 0;
    if (!S.next(0, cur)) return;
    f32x4 acc[2][2][4][2];
#pragma unroll
    for (int a = 0; a < 2; ++a)
#pragma unroll
        for (int b = 0; b < 2; ++b)
#pragma unroll
            for (int m = 0; m < 4; ++m)
#pragma unroll
                for (int n = 0; n < 2; ++n) acc[a][b][m][n] = (f32x4){0.f, 0.f, 0.f, 0.f};
    bf16x8 At[4][2], B0[2][2], B1[2][2];
    const char* cA = (const char*)g.A + (size_t)cur.pm * tstep; const char* cB = (const char*)g.Bt + (size_t)cur.pn * tstep;
    S.a_ready(cur);
    if constexpr (SP2) {
        PG8_STAGE(PG8_SB(0, 0), cB, voffB); PG8_STAGE(PG8_SB(0, 1), cB + hstep, voffB); PG8_STAGE(PG8_SA(0, 0), cA, voffA); PG8_STAGE(PG8_SA(0, 1), cA + hstep, voffA);
        if (wr == 1) PG8_BAR;
        PG8_WAIT_V(2); PG8_BAR;
        PG8_STAGE(PG8_SB(1, 0), cB + kstep, voffB); PG8_STAGE(PG8_SA(1, 0), cA + kstep, voffA); PG8_STAGE(PG8_SB(1, 1), cB + hstep + kstep, voffB);
        PG8_WAIT_V(6); PG8_BAR;
    } else {
        PG8_STAGE(PG8_SB(0, 0), cB, voffB); PG8_STAGE(PG8_SA(0, 0), cA, voffA); PG8_STAGE(PG8_SB(0, 1), cB + hstep, voffB); PG8_STAGE(PG8_SA(0, 1), cA + hstep, voffA);
        if (wr == 1) PG8_BAR;
        PG8_WAIT_V(4); PG8_BAR;
        PG8_STAGE(PG8_SB(1, 0), cB + kstep, voffB); PG8_STAGE(PG8_SA(1, 0), cA + kstep, voffA); PG8_STAGE(PG8_SB(1, 1), cB + hstep + kstep, voffB);
        PG8_WAIT_V(6); PG8_BAR;
    }
    for (;;) {
        const bool has_next = S.next(ui + 1, nxt);
        const char* nA = has_next ? (const char*)g.A + (size_t)nxt.pm * tstep : cA; const char* nB = has_next ? (const char*)g.Bt + (size_t)nxt.pn * tstep : cB;
        for (int t = 0; t < nt; t += 2) {
            const bool last = (t == nt - 2);
            const char* a1 = cA + (size_t)(t + 1) * kstep;
            const char* a2 = last ? nA : cA + (size_t)(t + 2) * kstep; const char* b2 = last ? nB : cB + (size_t)(t + 2) * kstep;
            const char* a3 = a2 + kstep; const char* b3 = b2 + kstep;
            if (last && has_next) S.a_ready(nxt);
            if constexpr (SP2) {
            PG8_LDB(B0, 0, 0); PG8_LDB(B1, 0, 1); PG8_SCHED; PG8_LDA(At, 0, 0); PG8_STAGE(PG8_SA(1, 1), a1 + hstep, voffA);
            PG8_WAIT_V(8); PG8_WAIT_L(0); PG8_BAR; PG8_MMA(0, 0, At, B0); PG8_MMA(0, 1, At, B1); PG8_BAR; PG8_SCHED;
            PG8_LDA(At, 0, 1); PG8_STAGE(PG8_SB(0, 0), b2, voffB); PG8_STAGE(PG8_SB(0, 1), b2 + hstep, voffB); PG8_STAGE(PG8_SA(0, 0), a2, voffA);
            PG8_WAIT_V(8); PG8_WAIT_L(0); PG8_BAR; PG8_MMA(1, 0, At, B0); PG8_MMA(1, 1, At, B1); PG8_BAR; PG8_SCHED;
            PG8_LDB(B0, 1, 0); PG8_LDB(B1, 1, 1); PG8_SCHED; PG8_LDA(At, 1, 0); PG8_STAGE(PG8_SA(0, 1), a2 + hstep, voffA);
            PG8_WAIT_V(8); PG8_WAIT_L(0); PG8_BAR; PG8_MMA(0, 0, At, B0); PG8_MMA(0, 1, At, B1); PG8_BAR; PG8_SCHED;
            PG8_LDA(At, 1, 1); PG8_STAGE(PG8_SB(1, 0), b3, voffB); PG8_STAGE(PG8_SB(1, 1), b3 + hstep, voffB); PG8_STAGE(PG8_SA(1, 0), a3, voffA);
            PG8_WAIT_V(8); PG8_WAIT_L(0); PG8_BAR; PG8_MMA(1, 0, At, B0); PG8_MMA(1, 1, At, B1); PG8_BAR; PG8_SCHED;
            } else {
            PG8_LDB(B0, 0, 0); PG8_SCHED; PG8_LDA(At, 0, 0); PG8_STAGE(PG8_SA(1, 1), a1 + hstep, voffA);
            PG8_WAIT_L(8); PG8_BAR; PG8_WAIT_L(0); PG8_MMA(0, 0, At, B0); PG8_BAR; PG8_SCHED;
            PG8_LDB(B1, 0, 1); PG8_STAGE(PG8_SB(0, 0), b2, voffB);
            PG8_BAR; PG8_WAIT_L(0); PG8_MMA(0, 1, At, B1); PG8_BAR;
            PG8_LDA(At, 0, 1); PG8_STAGE(PG8_SA(0, 0), a2, voffA);
            PG8_BAR; PG8_WAIT_L(0); PG8_MMA(1, 0, At, B0); PG8_BAR; PG8_SCHED;
            PG8_STAGE(PG8_SB(0, 1), b2 + hstep, voffB);
            PG8_WAIT_V(6); PG8_BAR; PG8_MMA(1, 1, At, B1); PG8_BAR;
            PG8_LDB(B0, 1, 0); PG8_SCHED; PG8_LDA(At, 1, 0); PG8_STAGE(PG8_SA(0, 1), a2 + hstep, voffA);
            PG8_WAIT_L(8); PG8_BAR; PG8_WAIT_L(0); PG8_MMA(0, 0, At, B0); PG8_BAR; PG8_SCHED;
            PG8_LDB(B1, 1, 1); PG8_STAGE(PG8_SB(1, 0), b3, voffB);
            PG8_BAR; PG8_WAIT_L(0); PG8_MMA(0, 1, At, B1); PG8_BAR;
            PG8_LDA(At, 1, 1); PG8_STAGE(PG8_SA(1, 0), a3, voffA);
            PG8_BAR; PG8_WAIT_L(0); PG8_MMA(1, 0, At, B0); PG8_BAR; PG8_SCHED;
            PG8_STAGE(PG8_SB(1, 1), b3 + hstep, voffB);
            PG8_WAIT_V(6); PG8_BAR; PG8_MMA(1, 1, At, B1); PG8_BAR;
            }
        }
        if constexpr (ALIGN_EPI) { if (wr == 0) PG8_BAR; }
        if constexpr (!Epi::AFTER_DRAIN) { E(acc, cur, wr, wc, fr, fq); S.done(cur); }
        if (!has_next) break;
#pragma unroll
        for (int a = 0; a < 2; ++a)
#pragma unroll
            for (int b = 0; b < 2; ++b)
#pragma unroll
                for (int m = 0; m < 4; ++m)
#pragma unroll
                    for (int n = 0; n < 2; ++n) acc[a][b][m][n] = (f32x4){0.f, 0.f, 0.f, 0.f};
        cur = nxt; cA = nA; cB = nB; ++ui;
        if constexpr (ALIGN_EPI) { if (wr == 1) PG8_BAR; }
    }
    PG8_WAIT_V(0);
    if constexpr (!ALIGN_EPI) { if (wr == 0) PG8_BAR; }
    PG8_BAR;
    if constexpr (Epi::AFTER_DRAIN) { E.fused(acc, cur, wr, wc, fr, fq, lds, wid, lane); S.done(cur); }
#undef PG8_SA
#undef PG8_SB
#undef PG8_STAGE
#undef PG8_LDA
#undef PG8_LDB
#undef PG8_MMA
#undef PG8_WAIT_V
#undef PG8_WAIT_L
#undef PG8_BAR
#undef PG8_SCHED
}
}
#define GAS __attribute__((address_space(1)))
#define LAS __attribute__((address_space(3)))
typedef unsigned short bf16;
typedef unsigned v4u __attribute__((ext_vector_type(4)));
typedef float f32x4 __attribute__((ext_vector_type(4)));
typedef short bf16x8 __attribute__((ext_vector_type(8)));
typedef GAS unsigned gu32;
typedef GAS unsigned long long gu64;
#define RLX_AGENT __ATOMIC_RELAXED, __HIP_MEMORY_SCOPE_AGENT
#define LDS_WAIT() asm volatile("s_waitcnt lgkmcnt(0)" ::: "memory")
#define VM_WAIT() asm volatile("s_waitcnt vmcnt(0)" ::: "memory")
__device__ __forceinline__ unsigned long long rt() { return __builtin_amdgcn_s_memrealtime(); }
__device__ __forceinline__ unsigned f2bf(float f) { unsigned u = __builtin_bit_cast(unsigned, f); return (u + 0x7fffu + ((u >> 16) & 1u)) >> 16; }
__device__ __forceinline__ unsigned pk2(float lo, float hi) { return f2bf(lo) | (f2bf(hi) << 16); }

#define XB_TMO      128
#define XB_XCNT(j)  (256  + 64 * (j))
#define XB_XSUB(j)  (1280 + 64 * (j))
#define XB_XGEN(j)  (2304 + 64 * (j))
#define XB_TOP      3328
#define XB_TOPGEN   3392
#define XCD_BAR_WORDS 3456
#define XB_SPIN_CAP (1u << 18)

__device__ __forceinline__ unsigned xb_ld(unsigned* p)              { return __hip_atomic_load(p, __ATOMIC_RELAXED, __HIP_MEMORY_SCOPE_AGENT); }
__device__ __forceinline__ unsigned xb_add(unsigned* p, unsigned v) { return __hip_atomic_fetch_add(p, v, __ATOMIC_RELAXED, __HIP_MEMORY_SCOPE_AGENT); }
__device__ __forceinline__ unsigned xb_xcc_id() { return (unsigned)__builtin_amdgcn_s_getreg((3 << 11) | 20) & 0xFu; }
#define XB_SPIN(cond, bar) do { unsigned _sp = 0; while (cond) { __builtin_amdgcn_s_sleep(1); \
    if ((++_sp & 255u) == 0u) { if (xb_ld(&(bar)[XB_TMO])) break; if (_sp > XB_SPIN_CAP) { atomicAdd(&(bar)[XB_TMO], 1u); break; } } } } while (0)

struct XcdBarrier {
    unsigned* bar; unsigned x;
    volatile LAS unsigned* st;
};

__device__ __forceinline__ XcdBarrier xcd_barrier_post(unsigned* bar, volatile LAS unsigned* st) {
    XcdBarrier b; b.bar = bar; b.x = xb_xcc_id(); b.st = st;
    if (threadIdx.x == 0) (void)xb_add(&bar[XB_XCNT(b.x)], 1u);
    return b;
}
__device__ __forceinline__ void xcd_barrier_complete(unsigned* bar, unsigned x, unsigned& nloc, unsigned& nx) {
    const unsigned G = gridDim.x * gridDim.y * gridDim.z;
    unsigned sum, cnt, mine, sp = 0u;
    for (;;) {
        sum = 0u; cnt = 0u; mine = 0u;
#pragma unroll
        for (unsigned j = 0; j < 16; ++j) { const unsigned c = xb_ld(&bar[XB_XCNT(j)]); sum += c; cnt += (c > 0u) ? 1u : 0u; mine = (j == x) ? c : mine; }
        if (sum == G) break;
        __builtin_amdgcn_s_sleep(1);
        if ((++sp & 255u) == 0u) { if (xb_ld(&bar[XB_TMO])) break; if (sp > XB_SPIN_CAP) { atomicAdd(&bar[XB_TMO], 1u); break; } }
    }
    nloc = mine > 0u ? mine : 1u; nx = cnt > 0u ? cnt : 1u;
}

__device__ __forceinline__ void xcd_barrier(const XcdBarrier& b) {
    asm volatile("s_waitcnt vmcnt(0)" ::: "memory");
    __syncthreads();
    if (threadIdx.x == 0) {
        unsigned* bar = b.bar;
        __builtin_amdgcn_s_waitcnt(0);
        unsigned nloc = b.st[0], nx = b.st[1];
        if (nloc == 0u) { xcd_barrier_complete(bar, b.x, nloc, nx); b.st[0] = nloc; b.st[1] = nx; }
        const unsigned old = xb_add(&bar[XB_XSUB(b.x)], 1u);
        const unsigned gen = old / nloc;
        if (old + 1u == (gen + 1u) * nloc) {
            __builtin_amdgcn_fence(__ATOMIC_RELEASE, "agent");
            asm volatile("s_waitcnt vmcnt(0)" ::: "memory");
            const unsigned og = xb_add(&bar[XB_TOP], 1u);
            const unsigned tg = og / nx;
            if (og + 1u == (tg + 1u) * nx) xb_add(&bar[XB_TOPGEN], 1u);
            else XB_SPIN(xb_ld(&bar[XB_TOPGEN]) == tg, bar);
            __builtin_amdgcn_fence(__ATOMIC_ACQUIRE, "agent");
            xb_add(&bar[XB_XGEN(b.x)], 1u);
            asm volatile("s_waitcnt vmcnt(0)" ::: "memory");
        } else {
            XB_SPIN(xb_ld(&bar[XB_XGEN(b.x)]) == gen, bar);
            __builtin_amdgcn_fence(__ATOMIC_ACQUIRE, "agent");
            asm volatile("s_waitcnt vmcnt(0)" ::: "memory");
        }
    }
    __syncthreads();
}

constexpr int NWAVES = 8;
constexpr int BATCH = 8, SEQ = 4096, DM = 1024, DIN = 5632, M = BATCH * SEQ, DH = 512;
constexpr float RMS_EPS = 1e-6f;
constexpr size_t MiB = 1u << 20;
constexpr size_t WS_CTL = 0, CTL_ZERO_BYTES = 1 * MiB;
constexpr size_t WS_RSS = 512 * 1024;
constexpr size_t WS_WIN = 2 * MiB, WS_WUA = 14 * MiB, WS_WUB = 15 * MiB, WS_WOUT = 16 * MiB, WS_WSP = 18 * MiB;
constexpr size_t WS_XN = 32 * MiB;
constexpr size_t WS_YA = 32 * MiB, WS_YB = 64 * MiB;
constexpr size_t WS_Q = 96 * MiB, WS_K = 128 * MiB, WS_V = 160 * MiB, WS_ZA = 192 * MiB, WS_UB = 224 * MiB, WS_VB = 256 * MiB, WS_ZB = 288 * MiB;
constexpr size_t WS_GA = 320 * MiB, WS_GB = 384 * MiB, WS_END = 448 * MiB;
constexpr size_t WS_MG = 96 * MiB;
constexpr int CW_BAR = 4096;
constexpr int RING_BYTES = 131072, P2_WAVE_BYTES = 17408, LDSCTL_OFF = 143360, MISC_OFF = LDSCTL_OFF + 320, LDS_BYTES = 147456;
static_assert(NWAVES * P2_WAVE_BYTES <= LDSCTL_OFF && MISC_OFF + 128 <= LDS_BYTES, "LDS map");

typedef float f32x16 __attribute__((ext_vector_type(16)));
typedef unsigned u32x4 __attribute__((ext_vector_type(4)));
typedef unsigned u32x2 __attribute__((ext_vector_type(2)));
typedef short s16x4 __attribute__((ext_vector_type(4)));
typedef float f32x2_t __attribute__((ext_vector_type(2))); typedef __bf16 bf16x2_t __attribute__((ext_vector_type(2)));
__device__ __forceinline__ unsigned cvtpk(float lo, float hi) { f32x2_t v = {lo, hi}; bf16x2_t b = __builtin_convertvector(v, bf16x2_t); return __builtin_bit_cast(unsigned, b); }
__device__ __forceinline__ float bf2f(bf16 b) { return __builtin_bit_cast(float, (unsigned)b << 16); }
__device__ __forceinline__ float bflo(unsigned w) { return __builtin_bit_cast(float, w << 16); }
__device__ __forceinline__ float bfhi(unsigned w) { return __builtin_bit_cast(float, w & 0xffff0000u); }
__device__ __forceinline__ int crow(int r, int hi) { return (r & 3) + 8 * (r >> 2) + 4 * hi; }
typedef short v4i16_t __attribute__((ext_vector_type(4)));
__device__ __forceinline__ s16x4 vtr(const LAS unsigned char* p) { return __builtin_bit_cast(s16x4, __builtin_amdgcn_ds_read_tr16_b64_v4i16((LAS v4i16_t*)p)); }

struct Frame {
    LAS unsigned char* lds; volatile LAS unsigned* MISC; gu32* ctl;
    int tid, lane, wave, vcu, G;
};

__device__ __forceinline__ float wave_sum(float v) {
#pragma unroll
    for (int o = 1; o < 64; o <<= 1) v += __shfl_xor(v, o);
    return v;
}
__device__ __forceinline__ void p0_transpose_item(const float* W, int K, int N, bf16* WT, LAS float* scr, int item, int lane) {
    const int nblk = N / 32, kb = item / nblk, nb = item % nblk, k0 = 64 * kb, n0 = 32 * nb;
#pragma unroll 8
    for (int i = 0; i < 32; ++i) { const int kk = 2 * i + (lane >> 5); scr[kk * 33 + (lane & 31)] = W[(size_t)(k0 + kk) * N + n0 + (lane & 31)]; }
    LDS_WAIT(); asm volatile("" ::: "memory");
    const int c = lane & 7;
#pragma unroll
    for (int j = 0; j < 4; ++j) { const int n = (lane >> 3) + 8 * j; const LAS float* s = scr + (8 * c) * 33 + n;
        v4u o; o.x = pk2(s[0 * 33], s[1 * 33]); o.y = pk2(s[2 * 33], s[3 * 33]); o.z = pk2(s[4 * 33], s[5 * 33]); o.w = pk2(s[6 * 33], s[7 * 33]);
        *(GAS v4u*)(WT + (size_t)(n0 + n) * K + k0 + 8 * c) = o; }
    LDS_WAIT(); asm volatile("" ::: "memory");
}
__device__ __forceinline__ void rms_row_to_bf16(int lane, const float* xrow, const float* g, bf16* orow) {
    const GAS f32x4* xr = (const GAS f32x4*)xrow + lane; const GAS f32x4* gr = (const GAS f32x4*)g + lane;
    f32x4 v[4]; float s = 0.f;
#pragma unroll
    for (int j = 0; j < 4; ++j) { v[j] = xr[64 * j]; s += (v[j].x * v[j].x + v[j].y * v[j].y) + (v[j].z * v[j].z + v[j].w * v[j].w); }
    const float rstd = 1.f / sqrtf(wave_sum(s) * (1.f / DM) + RMS_EPS);
    GAS unsigned long long* o8 = (GAS unsigned long long*)orow + lane;
#pragma unroll
    for (int j = 0; j < 4; ++j) { const f32x4 gg = gr[64 * j]; const f32x4 y = v[j] * rstd * gg;
        o8[64 * j] = (unsigned long long)pk2(y.x, y.y) | ((unsigned long long)pk2(y.z, y.w) << 32); }
}
struct P0Args { const float *x, *norm_g, *w_in, *w_sp, *w_up_a, *w_up_b, *w_out; bf16 *XN, *Win_t, *Wua_t, *Wub_t, *Wout_t, *Wsp; };
__device__ __forceinline__ void p0_prologue(Frame& F, const P0Args& A) {
    LAS float* scr = (LAS float*)(F.lds + F.wave * 16384);
    const int gw = F.vcu * NWAVES + F.wave, NGW = F.G * NWAVES;
    constexpr int I_IN = (DM / 64) * (DIN / 32), I_UP = (DH / 64) * (DM / 32), I_OUT = (DM / 64) * (DM / 32);
    constexpr int NITEMS = I_IN + 2 * I_UP + I_OUT;
    for (int it = gw; it < NITEMS; it += NGW) {
        int r = it;
        if (r < I_IN) { p0_transpose_item(A.w_in, DM, DIN, A.Win_t, scr, r, F.lane); continue; } r -= I_IN;
        if (r < I_UP) { p0_transpose_item(A.w_up_a, DH, DM, A.Wua_t, scr, r, F.lane); continue; } r -= I_UP;
        if (r < I_UP) { p0_transpose_item(A.w_up_b, DH, DM, A.Wub_t, scr, r, F.lane); continue; } r -= I_UP;
        p0_transpose_item(A.w_out, DM, DM, A.Wout_t, scr, r, F.lane);
    }
    for (int i = gw * 64 + F.lane; i < 8 * 128 * 128 / 2; i += NGW * 64) { const int e = 2 * i, s = e & 127, t = (e >> 7) & 127;
        const bool keep = (s >> 6) <= (t >> 6); const float a = keep ? A.w_sp[e] : 0.f, b = keep ? A.w_sp[e + 1] : 0.f;
        ((GAS unsigned*)A.Wsp)[i] = pk2(a, b); }
    for (int m = gw; m < M; m += NGW) rms_row_to_bf16(F.lane, A.x + (size_t)m * DM, A.norm_g, A.XN + (size_t)m * DM);
}

struct P2Args { const bf16 *Q, *K, *V, *ZA, *UB, *VB, *ZB; bf16 *YA, *YB; const bf16* Wsp; const float *ln_g, *ln_b, *b_sp; };
__device__ __forceinline__ void attn_wave_unit(int b, int h, int qb, const P2Args& A, LAS unsigned char* wl, int lane) {
    const int r32 = lane & 31, hi = lane >> 5;
    const size_t rowbase = (size_t)b * SEQ; const int t0 = qb * 32;
    bf16x8 qr[4];
#pragma unroll
    for (int ks = 0; ks < 4; ++ks) qr[ks] = *(const bf16x8*)(A.Q + (rowbase + t0 + r32) * DH + h * 64 + ks * 16 + hi * 8);
    f32x16 o0 = {}, o1 = {}; float E = 1.f;
    const LAS unsigned char* vrd = wl + (4 * hi + ((lane & 15) >> 2)) * 64 + ((lane >> 4) & 1) * 32 + (lane & 3) * 8;
    for (int kb = qb; kb >= 0; --kb) {
        const size_t key0 = rowbase + (size_t)kb * 32;
        u32x4 vv[4];
#pragma unroll
        for (int i = 0; i < 4; ++i) { const int pi = i * 64 + lane, k = pi >> 3, c = pi & 7; vv[i] = *(const u32x4*)(A.V + (key0 + k) * DH + h * 64 + c * 8); }
        bf16x8 kf[4];
#pragma unroll
        for (int ks = 0; ks < 4; ++ks) kf[ks] = *(const bf16x8*)(A.K + (key0 + r32) * DH + h * 64 + ks * 16 + hi * 8);
        f32x16 p = {};
#pragma unroll
        for (int ks = 0; ks < 4; ++ks) p = __builtin_amdgcn_mfma_f32_32x32x16_bf16(kf[ks], qr[ks], p, 0, 0, 0);
#pragma unroll
        for (int i = 0; i < 4; ++i) { const int pi = i * 64 + lane, k = pi >> 3, c = pi & 7; *(LAS u32x4*)(wl + (c >> 2) * 2048 + (k >> 3) * 512 + (k & 7) * 64 + (c & 3) * 16) = vv[i]; }
        const bool diag = (kb == qb);
        float w[16], gp[4];
#pragma unroll
        for (int gi = 0; gi < 4; ++gi) { float bt[4], kp[4];
#pragma unroll
            for (int i = 0; i < 4; ++i) { const int r = 4 * gi + i; const float e = __builtin_amdgcn_exp2f(fminf(-p[r], 100.f)); float b_ = __builtin_amdgcn_rcpf(1.f + e); float k_ = e * b_;
                if (diag) { const bool valid = crow(r, hi) < r32; b_ = valid ? b_ : 0.f; k_ = valid ? k_ : 1.f; }
                bt[i] = b_; kp[i] = k_; }
            const float x2 = kp[3], x1 = x2 * kp[2], x0 = x1 * kp[1]; gp[gi] = x0 * kp[0];
            w[4 * gi + 3] = bt[3]; w[4 * gi + 2] = bt[2] * x2; w[4 * gi + 1] = bt[1] * x1; w[4 * gi] = bt[0] * x0; }
        float oth[4], pr[4];
#pragma unroll
        for (int gi = 0; gi < 4; ++gi) { oth[gi] = __shfl_xor(gp[gi], 32); pr[gi] = gp[gi] * oth[gi]; }
        float sp[4]; sp[3] = 1.f; sp[2] = pr[3]; sp[1] = sp[2] * pr[2]; sp[0] = sp[1] * pr[1]; const float tot = sp[0] * pr[0];
#pragma unroll
        for (int gi = 0; gi < 4; ++gi) { const float sg = (hi ? 1.f : oth[gi]) * sp[gi] * E;
#pragma unroll
            for (int i = 0; i < 4; ++i) w[4 * gi + i] *= sg; }
        E *= tot;
        u32x4 pa0, pa1;
        pa0.x = cvtpk(w[0], w[1]); pa0.y = cvtpk(w[2], w[3]); pa0.z = cvtpk(w[4], w[5]); pa0.w = cvtpk(w[6], w[7]);
        pa1.x = cvtpk(w[8], w[9]); pa1.y = cvtpk(w[10], w[11]); pa1.z = cvtpk(w[12], w[13]); pa1.w = cvtpk(w[14], w[15]);
        const bf16x8 PA0 = __builtin_bit_cast(bf16x8, pa0), PA1 = __builtin_bit_cast(bf16x8, pa1);
#pragma unroll
        for (int d0 = 0; d0 < 2; ++d0) {
            const s16x4 a0 = vtr(vrd + d0 * 2048), a1 = vtr(vrd + d0 * 2048 + 512), b0 = vtr(vrd + d0 * 2048 + 1024), b1 = vtr(vrd + d0 * 2048 + 1536);
            const bf16x8 V0 = (bf16x8){a0[0], a0[1], a0[2], a0[3], a1[0], a1[1], a1[2], a1[3]}, V1 = (bf16x8){b0[0], b0[1], b0[2], b0[3], b1[0], b1[1], b1[2], b1[3]};
            if (d0 == 0) { o0 = __builtin_amdgcn_mfma_f32_32x32x16_bf16(PA0, V0, o0, 0, 0, 0); o0 = __builtin_amdgcn_mfma_f32_32x32x16_bf16(PA1, V1, o0, 0, 0, 0); }
            else         { o1 = __builtin_amdgcn_mfma_f32_32x32x16_bf16(PA0, V0, o1, 0, 0, 0); o1 = __builtin_amdgcn_mfma_f32_32x32x16_bf16(PA1, V1, o1, 0, 0, 0); }
        }
        if (__ballot(E != 0.f) == 0ull) break;
    }
#pragma unroll
    for (int r = 0; r < 16; ++r) { const size_t idx = (rowbase + t0 + crow(r, hi)) * DH + h * 64 + r32;
        const float z0 = bf2f(A.ZA[idx]), z1 = bf2f(A.ZA[idx + 32]);
        A.YA[idx] = (bf16)(cvtpk(o0[r] * z0, 0.f) & 0xffffu); A.YA[idx + 32] = (bf16)(cvtpk(o1[r] * z1, 0.f) & 0xffffu); }
}
constexpr int VN_PITCH = 272;
__device__ __forceinline__ void sgu_wave_unit(int b, int n, int g, const P2Args& A, LAS unsigned char* wl, int lane) {
    const int r32 = lane & 31, hi = lane >> 5;
    const size_t T0 = (size_t)b * SEQ + (size_t)n * 128;
    const float* lg = A.ln_g + g * 64; const float* lb = A.ln_b + g * 64;
#pragma unroll 1
    for (int tk = 0; tk < 2; ++tk) { const int s = lane + 64 * tk; const bf16* rowp = A.VB + (T0 + s) * DH + g * 64;
        float v[64];
#pragma unroll
        for (int j = 0; j < 8; ++j) { const u32x4 q = *(const u32x4*)(rowp + 8 * j);
            v[8 * j] = bflo(q.x); v[8 * j + 1] = bfhi(q.x); v[8 * j + 2] = bflo(q.y); v[8 * j + 3] = bfhi(q.y); v[8 * j + 4] = bflo(q.z); v[8 * j + 5] = bfhi(q.z); v[8 * j + 6] = bflo(q.w); v[8 * j + 7] = bfhi(q.w); }
        float sm = 0.f;
#pragma unroll
        for (int c = 0; c < 64; ++c) sm += v[c];
        const float mean = sm * (1.f / 64.f); float sq = 0.f;
#pragma unroll
        for (int c = 0; c < 64; ++c) { v[c] -= mean; sq += v[c] * v[c]; }
        const float rstd = 1.f / sqrtf(sq * (1.f / 64.f) + RMS_EPS);
#pragma unroll
        for (int c = 0; c < 64; ++c) { const float y = v[c] * rstd * lg[c] + lb[c]; *(LAS unsigned short*)(wl + c * VN_PITCH + s * 2) = (unsigned short)(cvtpk(y, 0.f) & 0xffffu); }
    }
    LDS_WAIT(); asm volatile("" ::: "memory");
    const bf16* Wg = A.Wsp + (size_t)g * 128 * 128;
#pragma unroll 1
    for (int tb = 0; tb < 4; ++tb) {
        f32x16 a0 = {}, a1 = {}; const int nks = (tb < 2) ? 4 : 8;
#pragma unroll 1
        for (int ks = 0; ks < nks; ++ks) {
            const bf16x8 wf = *(const bf16x8*)(Wg + (size_t)(32 * tb + r32) * 128 + ks * 16 + hi * 8);
            const bf16x8 f0 = *(const LAS bf16x8*)(wl + r32 * VN_PITCH + (ks * 16 + hi * 8) * 2), f1 = *(const LAS bf16x8*)(wl + (32 + r32) * VN_PITCH + (ks * 16 + hi * 8) * 2);
            a0 = __builtin_amdgcn_mfma_f32_32x32x16_bf16(f0, wf, a0, 0, 0, 0); a1 = __builtin_amdgcn_mfma_f32_32x32x16_bf16(f1, wf, a1, 0, 0, 0);
        }
        const float bias = A.b_sp[g * 128 + 32 * tb + r32];
        const size_t rowoff = (T0 + 32 * tb + r32) * DH + g * 64;
#pragma unroll
        for (int cb = 0; cb < 2; ++cb)
#pragma unroll
            for (int gi = 0; gi < 4; ++gi) { const size_t idx = rowoff + 32 * cb + 8 * gi + 4 * hi;
                const u32x2 ub = *(const u32x2*)(A.UB + idx), zb = *(const u32x2*)(A.ZB + idx);
                const f32x16& ac = cb ? a1 : a0;
                const float y0 = bflo(ub.x) * (ac[4 * gi] + bias) * bflo(zb.x), y1 = bfhi(ub.x) * (ac[4 * gi + 1] + bias) * bfhi(zb.x);
                const float y2 = bflo(ub.y) * (ac[4 * gi + 2] + bias) * bflo(zb.y), y3 = bfhi(ub.y) * (ac[4 * gi + 3] + bias) * bfhi(zb.y);
                u32x2 o; o.x = cvtpk(y0, y1); o.y = cvtpk(y2, y3); *(u32x2*)(A.YB + idx) = o; }
    }
    LDS_WAIT(); asm volatile("" ::: "memory");
}
__device__ __forceinline__ void p2_mixers(Frame& F, const P2Args& A) {
    LAS unsigned char* wl = F.lds + F.wave * P2_WAVE_BYTES;
    const int gw = F.vcu * NWAVES + F.wave, NGW = F.G * NWAVES;
    for (int u = gw; u < BATCH * 32 * 8; u += NGW) sgu_wave_unit(u >> 8, (u >> 3) & 31, u & 7, A, wl, F.lane);
    for (int u = gw; u < BATCH * 8 * 128; u += NGW) attn_wave_unit(u >> 10, (u >> 7) & 7, u & 127, A, wl, F.lane);
}
__device__ __forceinline__ void p5_final_norm(Frame& F, float* out, const float* gf) {
    const int gw = F.vcu * NWAVES + F.wave, NGW = F.G * NWAVES;
    for (int m = gw; m < M; m += NGW) {
        GAS f32x4* orow = (GAS f32x4*)(out + (size_t)m * DM) + F.lane; const GAS f32x4* gr = (const GAS f32x4*)gf + F.lane;
        f32x4 v[4]; float s = 0.f;
#pragma unroll
        for (int j = 0; j < 4; ++j) { v[j] = orow[64 * j]; s += (v[j].x * v[j].x + v[j].y * v[j].y) + (v[j].z * v[j].z + v[j].w * v[j].w); }
        const float rstd = 1.f / sqrtf(wave_sum(s) * (1.f / DM) + RMS_EPS);
#pragma unroll
        for (int j = 0; j < 4; ++j) orow[64 * j] = v[j] * rstd * gr[64 * j];
    }
}

#ifndef MK_N_LAUNCHES
#define MK_N_LAUNCHES 6
#endif
#ifndef MK_BARRIER
#define MK_BARRIER 0
#endif
constexpr int PER_PHASE = 6;
struct Args { const float* in[11]; float* out; unsigned char* ws; int ph_lo, ph_hi, pad0, pad1; };
__global__ void __launch_bounds__(NWAVES * 64, 2) fwd_kernel(Args args) {
    extern __shared__ __attribute__((aligned(16))) unsigned char lds[];
    Frame F;
    F.lds = (LAS unsigned char*)lds; F.MISC = (volatile LAS unsigned*)(F.lds + MISC_OFF);
    F.tid = threadIdx.x; F.lane = F.tid & 63; F.wave = __builtin_amdgcn_readfirstlane(F.tid >> 6);
    F.G = gridDim.x; { const int bx = blockIdx.x; F.vcu = (F.G % 8 == 0) ? (bx % 8) * (F.G / 8) + bx / 8 : bx; }
    unsigned char* ws = args.ws; F.ctl = (gu32*)(ws + WS_CTL);
    const float *x = args.in[0], *norm_g = args.in[1], *w_in = args.in[2], *ln_g = args.in[3], *ln_b = args.in[4], *w_sp = args.in[5], *b_sp = args.in[6],
                *w_up_a = args.in[7], *w_up_b = args.in[8], *w_out = args.in[9], *gf = args.in[10];
    bf16 *XN = (bf16*)(ws + WS_XN), *Win_t = (bf16*)(ws + WS_WIN), *Wua_t = (bf16*)(ws + WS_WUA), *Wub_t = (bf16*)(ws + WS_WUB), *Wout_t = (bf16*)(ws + WS_WOUT), *Wsp = (bf16*)(ws + WS_WSP);
    bf16 *Qb = (bf16*)(ws + WS_Q), *Kb = (bf16*)(ws + WS_K), *Vb = (bf16*)(ws + WS_V), *ZA = (bf16*)(ws + WS_ZA), *UB = (bf16*)(ws + WS_UB), *VB = (bf16*)(ws + WS_VB), *ZB = (bf16*)(ws + WS_ZB);
    bf16 *GA = (bf16*)(ws + WS_GA), *GB = (bf16*)(ws + WS_GB), *YA = (bf16*)(ws + WS_YA), *YB = (bf16*)(ws + WS_YB), *MG = (bf16*)(ws + WS_MG);
    const int lo = args.ph_lo, hi = args.ph_hi;
#define IN(k) (lo <= (k) && (k) < hi)
#define BOTH(k) (IN(k) && IN((k) + 1))
#if MK_N_LAUNCHES == 1 && MK_BARRIER == 0
    cooperative_groups::grid_group grid = cooperative_groups::this_grid();
#define GRID_BAR() grid.sync()
#elif MK_N_LAUNCHES == 1
    for (int u = F.tid; u < (LDS_BYTES - LDSCTL_OFF) / 4; u += NWAVES * 64) ((LAS unsigned*)(F.lds + LDSCTL_OFF))[u] = 0u;
    __syncthreads();
    XcdBarrier bar = xcd_barrier_post((unsigned*)(F.ctl + CW_BAR), F.MISC + 8);
#define GRID_BAR() xcd_barrier(bar)
#else
#define GRID_BAR() do {} while (0)
#endif
    if (IN(0)) { P0Args A{x, norm_g, w_in, w_sp, w_up_a, w_up_b, w_out, XN, Win_t, Wua_t, Wub_t, Wout_t, Wsp}; p0_prologue(F, A); if (BOTH(0)) GRID_BAR(); }
    if (IN(1)) {
        pg8::Gemm g{XN, Win_t, M, DIN, DM}; pg8::StaticOrder S; S.init(M, DIN, F.G, (int)blockIdx.x);
        pg8::EpiInProj E{ws + WS_Q, (size_t)(WS_K - WS_Q), (size_t)(WS_GA - WS_Q), (size_t)(WS_GB - WS_GA)};
        pg8::gemm_phase<pg8::EpiInProj, pg8::StaticOrder, true, true>(F.lds, g, S, E);
        if (BOTH(1)) GRID_BAR();
    }
    if (IN(2)) { P2Args A{Qb, Kb, Vb, ZA, UB, VB, ZB, YA, YB, Wsp, ln_g, ln_b, b_sp}; p2_mixers(F, A); if (BOTH(2)) GRID_BAR(); }
    if (IN(3)) {
        { pg8::Gemm g{YA, Wua_t, M, DM, DH}; pg8::StaticOrder S; S.init(M, DM, F.G, (int)blockIdx.x); pg8::EpiGate<0> E{GA, MG};
          pg8::gemm_phase<pg8::EpiGate<0>, pg8::StaticOrder, true, true>(F.lds, g, S, E); }
        { pg8::Gemm g{YB, Wub_t, M, DM, DH}; pg8::StaticOrder S; S.init(M, DM, F.G, (int)blockIdx.x); pg8::EpiGate<1> E{GB, MG};
          pg8::gemm_phase<pg8::EpiGate<1>, pg8::StaticOrder, true, true>(F.lds, g, S, E); }
        if (BOTH(3)) GRID_BAR();
    }
    if (IN(4)) {
        pg8::Gemm g{MG, Wout_t, M, DM, DM}; pg8::StaticOrder S; S.init(M, DM, F.G, (int)blockIdx.x); pg8::EpiResid E{x, args.out};
        pg8::gemm_phase<pg8::EpiResid, pg8::StaticOrder, true, true>(F.lds, g, S, E);
        if (BOTH(4)) GRID_BAR();
    }
    if (IN(5)) p5_final_norm(F, args.out, gf);
#undef IN
#undef BOTH
}

extern "C" void kernel_launch(void* const* d_in, const int* in_sizes, int n_in, void* d_out, int out_size, void* d_ws, size_t ws_size, hipStream_t stream) {
    static int grid = 0;
    if (grid == 0) {
        if (n_in != 11 || in_sizes[0] != M * DM || out_size != M * DM || ws_size < WS_END) { fprintf(stderr, "kernel_launch: unexpected shapes (n_in %d, in0 %d, out %d, ws %zu); nothing launched\n", n_in, n_in > 0 ? in_sizes[0] : -1, out_size, ws_size); grid = -1; return; }
        int dev = 0, cus = 0, per_cu = 0;
        if (hipGetDevice(&dev) != hipSuccess || hipDeviceGetAttribute(&cus, hipDeviceAttributeMultiprocessorCount, dev) != hipSuccess) { grid = -1; return; }
        if (hipFuncSetAttribute((const void*)fwd_kernel, hipFuncAttributeMaxDynamicSharedMemorySize, LDS_BYTES) != hipSuccess) { fprintf(stderr, "kernel_launch: hipFuncSetAttribute failed\n"); grid = -1; return; }
        if (hipOccupancyMaxActiveBlocksPerMultiprocessor(&per_cu, (const void*)fwd_kernel, NWAVES * 64, LDS_BYTES) != hipSuccess || per_cu < 1) { fprintf(stderr, "kernel_launch: occupancy query says %d blocks per CU\n", per_cu); per_cu = 1; }
        (void)hipGetLastError();
        grid = cus;
    }
    if (grid < 0) return;
#if MK_N_LAUNCHES == 1 && MK_BARRIER == 1
    (void)hipMemsetAsync((char*)d_ws + WS_CTL, 0, CTL_ZERO_BYTES, stream);
#endif
    Args a{};
    for (int i = 0; i < 11; ++i) a.in[i] = (const float*)d_in[i];
    a.out = (float*)d_out; a.ws = (unsigned char*)d_ws;
#if MK_N_LAUNCHES == 1
    a.ph_lo = 0; a.ph_hi = PER_PHASE;
#if MK_BARRIER == 0
    void* kargs[] = {&a};
    hipError_t e = hipLaunchCooperativeKernel((const void*)fwd_kernel, dim3(grid), dim3(NWAVES * 64), kargs, LDS_BYTES, stream);
    if (e != hipSuccess) fprintf(stderr, "kernel_launch: cooperative launch failed: %s (grid %d)\n", hipGetErrorString(e), grid);
#else
    hipLaunchKernelGGL(fwd_kernel, dim3(grid), dim3(NWAVES * 64), LDS_BYTES, stream, a);
#endif
#else
    for (int li = 0; li < PER_PHASE; ++li) { a.ph_lo = li; a.ph_hi = li + 1; hipLaunchKernelGGL(fwd_kernel, dim3(grid), dim3(NWAVES * 64), LDS_BYTES, stream, a); }
#endif
}
```
